# Optimizing an MI355X kernel written in HIP

```python
import jax, jax.numpy as jnp
from jax import lax
import numpy as np

D_MODEL = 1024
BATCH = 8
SEQ = 2048
DEPTH = 2

N_A_LAYERS = DEPTH // 2
N_B_LAYERS = DEPTH - N_A_LAYERS
POOL_WINDOWS = (2, 4, 8, 16)
N_POOL_GROUPS = len(POOL_WINDOWS)
POOL_GROUP = D_MODEL // N_POOL_GROUPS
HEAD_DIM = 64
N_HEADS = D_MODEL // HEAD_DIM
N_KV_HEADS = 4
GQA_GROUP = N_HEADS // N_KV_HEADS
WINDOW = 128
BLOCK = 128
D_FF = -(-8 * D_MODEL // (3 * 256)) * 256
PLE_DIM = 256
EPS = 1e-6
NEG_INF = -1e30

kernel_name = "yoco_pool_swa_sink_hybrid"


def rmsnorm(x, g):
    xf = x.astype(jnp.float32)
    y = xf * lax.rsqrt(jnp.mean(xf * xf, axis=-1, keepdims=True) + EPS)
    return (y * g.astype(jnp.float32)).astype(x.dtype)


def causal_multiscale_pool(h):
    B, S, C = h.shape
    hf = h.astype(jnp.float32)
    cp = jnp.concatenate([jnp.zeros((B, 1, C), jnp.float32), jnp.cumsum(hf, axis=1)], axis=1)
    pos1 = jnp.arange(1, S + 1, dtype=jnp.int32)
    outs = []
    for gi, w in enumerate(POOL_WINDOWS):
        sl = cp[:, :, gi * POOL_GROUP:(gi + 1) * POOL_GROUP]
        hi = sl[:, 1:]
        lo = jnp.concatenate([jnp.zeros((B, w - 1, POOL_GROUP), jnp.float32),
                              sl[:, :S - w + 1]], axis=1)
        cnt = jnp.minimum(pos1, w).astype(jnp.float32)[None, :, None]
        outs.append((hi - lo) / cnt)
    pooled = jnp.concatenate(outs, axis=-1)
    return (pooled - hf).astype(h.dtype)


def pool_mixer(h, w_pool, scale):
    B, S, _ = h.shape
    d = causal_multiscale_pool(h).reshape(B, S, N_POOL_GROUPS, POOL_GROUP)
    y = jnp.einsum('bsgc,gcd->bsgd', d, w_pool).reshape(B, S, D_MODEL)
    return y * scale


def alibi_slopes():
    h = jnp.arange(1, N_HEADS + 1, dtype=jnp.float32)
    return jnp.exp2(-8.0 * h / N_HEADS).reshape(N_KV_HEADS, GQA_GROUP)


def swa_sink_attention(q, k, v, sinks):
    B, S = q.shape[:2]
    nb = S // BLOCK
    qb = q.reshape(B, nb, BLOCK, N_KV_HEADS, GQA_GROUP, HEAD_DIM)
    kb = k.reshape(B, nb, BLOCK, N_KV_HEADS, HEAD_DIM)
    vb = v.reshape(B, nb, BLOCK, N_KV_HEADS, HEAD_DIM)
    pad = ((0, 0), (1, 0), (0, 0), (0, 0), (0, 0))
    kwin = jnp.concatenate([jnp.pad(kb, pad)[:, :-1], kb], axis=2)
    vwin = jnp.concatenate([jnp.pad(vb, pad)[:, :-1], vb], axis=2)
    scores = jnp.einsum('bnqkgd,bnskd->bnkgqs', qb, kwin,
                        preferred_element_type=jnp.float32) * (HEAD_DIM ** -0.5)
    qi = jnp.arange(BLOCK)[:, None]
    si = jnp.arange(2 * BLOCK)[None, :]
    rel = BLOCK + qi - si
    kpos = (jnp.arange(nb)[:, None, None] - 1) * BLOCK + si[None]
    valid = (rel >= 0)[None] & (rel < WINDOW)[None] & (kpos >= 0)
    bias = -alibi_slopes()[:, :, None, None] * rel.astype(jnp.float32)
    scores = jnp.where(valid[None, :, None, None], scores + bias[None, None], NEG_INF)
    sink = jnp.broadcast_to(sinks.astype(jnp.float32).reshape(N_KV_HEADS, GQA_GROUP)[None, None, :, :, None, None],
                            scores.shape[:-1] + (1,))
    probs = jax.nn.softmax(jnp.concatenate([scores, sink], axis=-1), axis=-1)[..., :-1]
    out = jnp.einsum('bnkgqs,bnskd->bnqkgd', probs.astype(v.dtype), vwin)
    return out.reshape(B, S, N_HEADS * HEAD_DIM)


def swiglu(h, w_gu, w_down):
    gu = h @ w_gu
    g, u = gu[..., :D_FF], gu[..., D_FF:]
    return (jax.nn.silu(g) * u) @ w_down


def setup_inputs(seed: int = 0) -> dict:
    key = jax.random.key(seed)
    ks = jax.random.split(key, 24)
    f32 = jnp.float32
    nrm = lambda k, s, fan: jax.random.normal(k, s, f32) * (fan ** -0.5)
    gain = lambda k, s: 1.0 + 0.1 * jax.random.normal(k, s, f32)
    KV = N_KV_HEADS * HEAD_DIM
    QD = N_HEADS * HEAD_DIM
    return {
        "x": jax.random.normal(ks[0], (BATCH, SEQ, D_MODEL), f32),
        "p": jax.random.normal(ks[1], (DEPTH, BATCH, SEQ, PLE_DIM), f32),
        "pre_mix_g": gain(ks[2], (DEPTH, D_MODEL)),
        "post_mix_g": gain(ks[3], (DEPTH, D_MODEL)),
        "pre_ffn_g": gain(ks[4], (DEPTH, D_MODEL)),
        "post_ffn_g": gain(ks[5], (DEPTH, D_MODEL)),
        "pool_w": nrm(ks[6], (N_A_LAYERS, N_POOL_GROUPS, POOL_GROUP, POOL_GROUP), POOL_GROUP),
        "pool_scale": gain(ks[7], (N_A_LAYERS, D_MODEL)),
        "kv_g": gain(ks[8], (D_MODEL,)),
        "w_kv": nrm(ks[9], (D_MODEL, 2 * KV), D_MODEL),
        "w_q": nrm(ks[10], (N_B_LAYERS, D_MODEL, QD), D_MODEL),
        "sinks": 0.5 * jax.random.normal(ks[11], (N_B_LAYERS, N_HEADS), f32),
        "w_o": nrm(ks[12], (N_B_LAYERS, QD, D_MODEL), QD),
        "w_gu": nrm(ks[13], (DEPTH, D_MODEL, 2 * D_FF), D_MODEL),
        "w_down": nrm(ks[14], (DEPTH, D_FF, D_MODEL), D_FF),
        "ple_g": gain(ks[15], (DEPTH, D_MODEL)),
        "w_ple_gate": nrm(ks[16], (DEPTH, D_MODEL, D_MODEL), D_MODEL),
        "w_ple_proj": nrm(ks[17], (DEPTH, PLE_DIM, D_MODEL), PLE_DIM),
        "ple_post_g": gain(ks[18], (DEPTH, D_MODEL)),
    }


def reference(x, p, pre_mix_g, post_mix_g, pre_ffn_g, post_ffn_g, pool_w, pool_scale,
              kv_g, w_kv, w_q, sinks, w_o, w_gu, w_down, ple_g, w_ple_gate, w_ple_proj,
              ple_post_g):
    B, S, _ = x.shape
    KV = N_KV_HEADS * HEAD_DIM
    k = v = None
    for i in range(DEPTH):
        h = rmsnorm(x, pre_mix_g[i])
        if i < N_A_LAYERS:
            y = pool_mixer(h, pool_w[i], pool_scale[i])
        else:
            b = i - N_A_LAYERS
            q = (h @ w_q[b]).reshape(B, S, N_HEADS, HEAD_DIM)
            y = swa_sink_attention(q, k, v, sinks[b]) @ w_o[b]
        x = x + rmsnorm(y, post_mix_g[i])
        h = rmsnorm(x, pre_ffn_g[i])
        x = x + rmsnorm(swiglu(h, w_gu[i], w_down[i]), post_ffn_g[i])
        gate = jax.nn.sigmoid(rmsnorm(x, ple_g[i]) @ w_ple_gate[i])
        e = (p[i].astype(x.dtype) @ w_ple_proj[i]) * gate
        x = x + rmsnorm(e, ple_post_g[i])
        if i == N_A_LAYERS - 1:
            kv = rmsnorm(x, kv_g) @ w_kv
            k = kv[..., :KV].reshape(B, S, N_KV_HEADS, HEAD_DIM)
            v = kv[..., KV:].reshape(B, S, N_KV_HEADS, HEAD_DIM)
    return x
```

```cpp
#include <hip/hip_runtime.h>
#include <cstdio>
#include <cstdint>

typedef unsigned short bf16_t;
typedef short bf16x8 __attribute__((ext_vector_type(8)));
typedef float f32x4 __attribute__((ext_vector_type(4)));
typedef unsigned u32x2 __attribute__((ext_vector_type(2)));

constexpr int BATCH = 8, SEQ = 2048, DM = 1024, T = BATCH * SEQ, FF = 2816, PLE = 256, KVD = 256, NH = 16, HD = 64;
constexpr float EPS = 1e-6f;
constexpr float LOG2E = 1.4426950408889634f;
constexpr float C2 = 0.125f * LOG2E;

constexpr size_t MiB = 1u << 20;
constexpr size_t WS_CTL = 0;
constexpr size_t WS_RSTD = 1 * MiB;
constexpr size_t WS_WPOOL = 2 * MiB;
constexpr size_t WS_WPROJ = WS_WPOOL + (size_t)1024 * 256 * 2;
constexpr size_t WS_WGATE = WS_WPROJ + (size_t)2 * 1024 * 256 * 2;
constexpr size_t WS_WQKV = WS_WGATE + (size_t)2 * 1024 * 1024 * 2;
constexpr size_t WS_WO = WS_WQKV + (size_t)1536 * 1024 * 2;
constexpr size_t WS_WGU = WS_WO + (size_t)1024 * 1024 * 2;
constexpr size_t WS_WDOWN = WS_WGU + (size_t)2 * 5632 * 1024 * 2;
constexpr size_t WS_WEND = WS_WDOWN + (size_t)2 * 1024 * 2816 * 2;
static_assert(WS_WEND <= 46 * MiB, "weights");
constexpr size_t WS_XCH = 46 * MiB;
constexpr size_t WS_H = 48 * MiB;
constexpr size_t WS_PROJ = 80 * MiB;
constexpr size_t WS_PB = 112 * MiB;
constexpr size_t WS_ACT = 128 * MiB;
constexpr size_t WS_D = WS_ACT;
constexpr size_t WS_Q = WS_ACT;
constexpr size_t WS_K = WS_ACT + 32 * MiB;
constexpr size_t WS_V = WS_ACT + 40 * MiB;
constexpr size_t WS_END = 216 * MiB;

__device__ __forceinline__ unsigned f2bf(float f) { unsigned u = __builtin_bit_cast(unsigned, f); return (u + 0x7fffu + ((u >> 16) & 1u)) >> 16; }
__device__ __forceinline__ float bf2f(unsigned b) { return __builtin_bit_cast(float, b << 16); }
__device__ __forceinline__ unsigned pk2(float lo, float hi) { return f2bf(lo) | (f2bf(hi) << 16); }

__global__ void prep_w(const float* __restrict__ W, int ldw, int K, int Nrows, bf16_t* __restrict__ out, int mode, const float* __restrict__ gk, const float* __restrict__ gc) {
    const size_t idx = (size_t)blockIdx.x * blockDim.x + threadIdx.x;
    if (idx >= (size_t)Nrows * K) return;
    const int n = (int)(idx / K), k = (int)(idx % K);
    int c = n;
    if (mode == 1) { const int t = n >> 8, j = n & 255; c = (j < 128) ? (128 * t + j) : (FF + 128 * t + (j - 128)); }
    float v = W[(size_t)k * ldw + c];
    if (gk) v *= gk[k];
    if (gc) v *= gc[c];
    out[idx] = (bf16_t)f2bf(v);
}

__global__ void cvt_bf16(const float* __restrict__ in, bf16_t* __restrict__ out, size_t n) {
    const size_t idx = (size_t)blockIdx.x * blockDim.x + threadIdx.x;
    if (idx < n) out[idx] = (bf16_t)f2bf(in[idx]);
}

__global__ void rstd_rows(const float* __restrict__ x, float* __restrict__ rstd) {
    const int row = blockIdx.x * 4 + (threadIdx.x >> 6), lane = threadIdx.x & 63;
    const float* xr = x + (size_t)row * DM;
    float s = 0.f;
    for (int i = lane; i < DM; i += 64) { const float v = xr[i]; s += v * v; }
    for (int o = 1; o < 64; o <<= 1) s += __shfl_xor(s, o);
    if (lane == 0) rstd[row] = 1.0f / sqrtf(s * (1.0f / DM) + EPS);
}

__global__ void pool_d(const float* __restrict__ x, const float* __restrict__ rstd, bf16_t* __restrict__ d) {
    const size_t idx = (size_t)blockIdx.x * blockDim.x + threadIdx.x;
    const int t = (int)(idx >> 10), c = (int)(idx & 1023);
    const int g = c >> 8, w = 2 << g, pos = t % SEQ;
    const int cnt = (pos + 1 < w) ? (pos + 1) : w;
    float s = 0.f;
    for (int j = 0; j < cnt; ++j) s += x[(size_t)(t - j) * DM + c] * rstd[t - j];
    const float h = x[idx] * rstd[t];
    d[idx] = (bf16_t)f2bf(s / (float)cnt - h);
}

template <int MODE>
__global__ void __launch_bounds__(256) gemm_tile(const bf16_t* __restrict__ A, int lda, const bf16_t* __restrict__ Bt, int K, bf16_t* __restrict__ O, int ldc, bf16_t* __restrict__ O2, bf16_t* __restrict__ O3) {
    const int wave = threadIdx.x >> 6, lane = threadIdx.x & 63, fr = lane & 15, fq = lane >> 4;
    const int row0 = blockIdx.x * 64 + wave * 16, col0 = blockIdx.y * 256;
    f32x4 acc[16];
#pragma unroll
    for (int n = 0; n < 16; ++n) acc[n] = (f32x4){0.f, 0.f, 0.f, 0.f};
    const bf16_t* ap = A + (size_t)(row0 + fr) * lda + 8 * fq;
    const bf16_t* bp = Bt + (size_t)(col0 + fr) * K + 8 * fq;
    for (int k0 = 0; k0 < K; k0 += 32) {
        const bf16x8 a = *(const bf16x8*)(ap + k0);
#pragma unroll
        for (int n = 0; n < 16; ++n) {
            const bf16x8 b = *(const bf16x8*)(bp + (size_t)n * 16 * K + k0);
            acc[n] = __builtin_amdgcn_mfma_f32_16x16x32_bf16(b, a, acc[n], 0, 0, 0);
        }
    }
    const int row = row0 + fr;
    if (MODE == 0) {
#pragma unroll
        for (int n = 0; n < 16; ++n) { u32x2 w; w.x = pk2(acc[n][0], acc[n][1]); w.y = pk2(acc[n][2], acc[n][3]); *(u32x2*)(O + (size_t)row * ldc + col0 + 16 * n + 4 * fq) = w; }
    } else if (MODE == 1) {
#pragma unroll
        for (int n = 0; n < 8; ++n) {
            float r[4];
#pragma unroll
            for (int i = 0; i < 4; ++i) { const float g = acc[n][i], u = acc[n + 8][i]; r[i] = g / (1.0f + __expf(-g)) * u; }
            u32x2 w; w.x = pk2(r[0], r[1]); w.y = pk2(r[2], r[3]);
            *(u32x2*)(O + (size_t)row * FF + 128 * blockIdx.y + 16 * n + 4 * fq) = w;
        }
    } else {
        const int tile = blockIdx.y;
        bf16_t* base; int ld, cb; float sc = 1.f;
        if (tile < 4) { base = O; ld = DM; cb = 256 * tile; sc = C2; } else if (tile == 4) { base = O2; ld = KVD; cb = 0; } else { base = O3; ld = KVD; cb = 0; }
#pragma unroll
        for (int n = 0; n < 16; ++n) { u32x2 w; w.x = pk2(acc[n][0] * sc, acc[n][1] * sc); w.y = pk2(acc[n][2] * sc, acc[n][3] * sc); *(u32x2*)(base + (size_t)row * ld + cb + 16 * n + 4 * fq) = w; }
    }
}

template <bool GATE, bool HN>
__global__ void __launch_bounds__(256) gemm_rows(const bf16_t* A, int lda, int a_wave_off, const bf16_t* __restrict__ Bt, int K, const float* xold, float* xnew,
                                                 const float* __restrict__ gpost, const bf16_t* __restrict__ proj, bf16_t* hn) {
    __shared__ float red[2][4][16];
    const int wave = threadIdx.x >> 6, lane = threadIdx.x & 63, fr = lane & 15, fq = lane >> 4;
    const int row0 = blockIdx.x * 16, col0 = wave * 256;
    f32x4 acc[16];
#pragma unroll
    for (int n = 0; n < 16; ++n) acc[n] = (f32x4){0.f, 0.f, 0.f, 0.f};
    const bf16_t* ap = A + (size_t)(row0 + fr) * lda + wave * a_wave_off + 8 * fq;
    const bf16_t* bp = Bt + (size_t)(col0 + fr) * K + 8 * fq;
    for (int k0 = 0; k0 < K; k0 += 32) {
        const bf16x8 a = *(const bf16x8*)(ap + k0);
#pragma unroll
        for (int n = 0; n < 16; ++n) {
            const bf16x8 b = *(const bf16x8*)(bp + (size_t)n * 16 * K + k0);
            acc[n] = __builtin_amdgcn_mfma_f32_16x16x32_bf16(b, a, acc[n], 0, 0, 0);
        }
    }
    const int row = row0 + fr;
    float ss = 0.f;
#pragma unroll
    for (int n = 0; n < 16; ++n) {
        const int col = col0 + 16 * n + 4 * fq;
        if (GATE) {
            const u32x2 pw = *(const u32x2*)(proj + (size_t)row * DM + col);
            const float p0 = bf2f(pw.x & 0xffffu), p1 = bf2f(pw.x >> 16), p2 = bf2f(pw.y & 0xffffu), p3 = bf2f(pw.y >> 16);
            acc[n][0] = p0 / (1.0f + __expf(-acc[n][0])); acc[n][1] = p1 / (1.0f + __expf(-acc[n][1]));
            acc[n][2] = p2 / (1.0f + __expf(-acc[n][2])); acc[n][3] = p3 / (1.0f + __expf(-acc[n][3]));
        }
        ss += (acc[n][0] * acc[n][0] + acc[n][1] * acc[n][1]) + (acc[n][2] * acc[n][2] + acc[n][3] * acc[n][3]);
    }
    ss += __shfl_xor(ss, 16); ss += __shfl_xor(ss, 32);
    if (fq == 0) red[0][wave][fr] = ss;
    __syncthreads();
    const float tot = (red[0][0][fr] + red[0][1][fr]) + (red[0][2][fr] + red[0][3][fr]);
    const float rs = 1.0f / sqrtf(tot * (1.0f / DM) + EPS);
    float ss2 = 0.f;
#pragma unroll
    for (int n = 0; n < 16; ++n) {
        const int col = col0 + 16 * n + 4 * fq;
        const f32x4 xo = *(const f32x4*)(xold + (size_t)row * DM + col);
        const f32x4 gp = *(const f32x4*)(gpost + col);
        f32x4 xn = xo + acc[n] * rs * gp;
        *(f32x4*)(xnew + (size_t)row * DM + col) = xn;
        acc[n] = xn;
        ss2 += (xn[0] * xn[0] + xn[1] * xn[1]) + (xn[2] * xn[2] + xn[3] * xn[3]);
    }
    if (HN) {
        ss2 += __shfl_xor(ss2, 16); ss2 += __shfl_xor(ss2, 32);
        if (fq == 0) red[1][wave][fr] = ss2;
        __syncthreads();
        const float tot2 = (red[1][0][fr] + red[1][1][fr]) + (red[1][2][fr] + red[1][3][fr]);
        const float rs2 = 1.0f / sqrtf(tot2 * (1.0f / DM) + EPS);
#pragma unroll
        for (int n = 0; n < 16; ++n) {
            const int col = col0 + 16 * n + 4 * fq;
            u32x2 w; w.x = pk2(acc[n][0] * rs2, acc[n][1] * rs2); w.y = pk2(acc[n][2] * rs2, acc[n][3] * rs2);
            *(u32x2*)(hn + (size_t)row * DM + col) = w;
        }
    }
}

__global__ void __launch_bounds__(256) attn_naive(const bf16_t* Q, const bf16_t* __restrict__ Kb, const bf16_t* __restrict__ Vb, const float* __restrict__ sinks, bf16_t* O) {
    const int wave = threadIdx.x >> 6, lane = threadIdx.x & 63;
    const int id = blockIdx.x * 4 + wave, t = id >> 4, h = id & 15, kvh = h >> 2, pos = t % SEQ;
    const float slope2 = exp2f(-0.5f * (float)(h + 1)) * LOG2E;
    const float sink2 = sinks[h] * LOG2E;
    const bf16_t* qp = Q + (size_t)t * DM + h * HD;
    float q[HD];
#pragma unroll
    for (int d = 0; d < HD; ++d) q[d] = bf2f(qp[d]);
    float s[2];
#pragma unroll
    for (int half = 0; half < 2; ++half) {
        const int rel = lane + 64 * half;
        float a = -1e30f;
        if (rel <= pos) {
            const bf16_t* kp = Kb + (size_t)(t - rel) * KVD + kvh * HD;
            float dsum = 0.f;
#pragma unroll
            for (int d = 0; d < HD; ++d) dsum += q[d] * bf2f(kp[d]);
            a = dsum - slope2 * (float)rel;
        }
        s[half] = a;
    }
    float m = fmaxf(fmaxf(s[0], s[1]), sink2);
    for (int o = 1; o < 64; o <<= 1) m = fmaxf(m, __shfl_xor(m, o));
    const float p0 = (s[0] > -1e29f) ? exp2f(s[0] - m) : 0.f, p1 = (s[1] > -1e29f) ? exp2f(s[1] - m) : 0.f;
    float l = p0 + p1;
    for (int o = 1; o < 64; o <<= 1) l += __shfl_xor(l, o);
    l += exp2f(sink2 - m);
    float o_acc = 0.f;
    const int nrel = (pos + 1 < 128) ? (pos + 1) : 128;
    for (int rel = 0; rel < nrel; ++rel) {
        const float p = (rel < 64) ? __shfl(p0, rel) : __shfl(p1, rel - 64);
        o_acc += p * bf2f(Vb[(size_t)(t - rel) * KVD + kvh * HD + lane]);
    }
    O[(size_t)t * DM + h * HD + lane] = (bf16_t)f2bf(o_acc / l);
}

extern "C" void kernel_launch(void* const* d_in, const int* in_sizes, int n_in, void* d_out, int out_size, void* d_ws, size_t ws_size, hipStream_t stream) {
    if (n_in != 19 || out_size != T * DM || ws_size < WS_END) { fprintf(stderr, "kernel_launch: unexpected shapes (n_in %d out %d ws %zu)\n", n_in, out_size, ws_size); return; }
    const float* x = (const float*)d_in[0]; const float* p = (const float*)d_in[1];
    const float* pre_mix_g = (const float*)d_in[2]; const float* post_mix_g = (const float*)d_in[3];
    const float* pre_ffn_g = (const float*)d_in[4]; const float* post_ffn_g = (const float*)d_in[5];
    const float* pool_w = (const float*)d_in[6]; const float* pool_scale = (const float*)d_in[7];
    const float* kv_g = (const float*)d_in[8]; const float* w_kv = (const float*)d_in[9];
    const float* w_q = (const float*)d_in[10]; const float* sinks = (const float*)d_in[11]; const float* w_o = (const float*)d_in[12];
    const float* w_gu = (const float*)d_in[13]; const float* w_down = (const float*)d_in[14];
    const float* ple_g = (const float*)d_in[15]; const float* w_gate = (const float*)d_in[16]; const float* w_proj = (const float*)d_in[17]; const float* ple_post_g = (const float*)d_in[18];
    float* out = (float*)d_out; unsigned char* ws = (unsigned char*)d_ws;
    float* rstd0 = (float*)(ws + WS_RSTD);
    bf16_t* WpoolT = (bf16_t*)(ws + WS_WPOOL); bf16_t* WprojT = (bf16_t*)(ws + WS_WPROJ); bf16_t* WgateT = (bf16_t*)(ws + WS_WGATE); bf16_t* WqkvT = (bf16_t*)(ws + WS_WQKV);
    bf16_t* WoT = (bf16_t*)(ws + WS_WO); bf16_t* WguT = (bf16_t*)(ws + WS_WGU); bf16_t* WdownT = (bf16_t*)(ws + WS_WDOWN);
    bf16_t* H = (bf16_t*)(ws + WS_H); bf16_t* PROJ = (bf16_t*)(ws + WS_PROJ); bf16_t* PB = (bf16_t*)(ws + WS_PB); bf16_t* ACT = (bf16_t*)(ws + WS_ACT);
    bf16_t* Dp = (bf16_t*)(ws + WS_D); bf16_t* Qb = (bf16_t*)(ws + WS_Q); bf16_t* Kb = (bf16_t*)(ws + WS_K); bf16_t* Vb = (bf16_t*)(ws + WS_V);

    auto PW = [&](const float* W, int ldw, int K, int Nrows, bf16_t* o, int mode, const float* gk, const float* gc) {
        const size_t n = (size_t)Nrows * K; prep_w<<<(unsigned)((n + 255) / 256), 256, 0, stream>>>(W, ldw, K, Nrows, o, mode, gk, gc); };
    for (int g = 0; g < 4; ++g) PW(pool_w + (size_t)g * 65536, 256, 256, 256, WpoolT + (size_t)g * 65536, 0, pre_mix_g + g * 256, pool_scale + g * 256);
    for (int l = 0; l < 2; ++l) {
        PW(w_proj + (size_t)l * 256 * 1024, 1024, 256, 1024, WprojT + (size_t)l * 1024 * 256, 0, nullptr, nullptr);
        PW(w_gate + (size_t)l * 1024 * 1024, 1024, 1024, 1024, WgateT + (size_t)l * 1024 * 1024, 0, ple_g + l * 1024, nullptr);
        PW(w_gu + (size_t)l * 1024 * 5632, 5632, 1024, 5632, WguT + (size_t)l * 5632 * 1024, 1, pre_ffn_g + l * 1024, nullptr);
        PW(w_down + (size_t)l * 2816 * 1024, 1024, 2816, 1024, WdownT + (size_t)l * 1024 * 2816, 0, nullptr, nullptr);
    }
    PW(w_q, 1024, 1024, 1024, WqkvT, 0, pre_mix_g + 1024, nullptr);
    PW(w_kv, 512, 1024, 512, WqkvT + (size_t)1024 * 1024, 0, kv_g, nullptr);
    PW(w_o, 1024, 1024, 1024, WoT, 0, nullptr, nullptr);
    cvt_bf16<<<(unsigned)(((size_t)2 * T * PLE + 255) / 256), 256, 0, stream>>>(p, PB, (size_t)2 * T * PLE);
    rstd_rows<<<T / 4, 256, 0, stream>>>(x, rstd0);
    pool_d<<<(unsigned)((size_t)T * DM / 256), 256, 0, stream>>>(x, rstd0, Dp);

    gemm_rows<false, true><<<T / 16, 256, 0, stream>>>(Dp, DM, 256, WpoolT, 256, x, out, post_mix_g, nullptr, H);
    gemm_tile<1><<<dim3(T / 64, 22), 256, 0, stream>>>(H, DM, WguT, 1024, ACT, FF, nullptr, nullptr);
    gemm_rows<false, true><<<T / 16, 256, 0, stream>>>(ACT, FF, 0, WdownT, FF, out, out, post_ffn_g, nullptr, H);
    gemm_tile<0><<<dim3(T / 64, 4), 256, 0, stream>>>(PB, PLE, WprojT, 256, PROJ, DM, nullptr, nullptr);
    gemm_rows<true, true><<<T / 16, 256, 0, stream>>>(H, DM, 0, WgateT, 1024, out, out, ple_post_g, PROJ, H);
    gemm_tile<2><<<dim3(T / 64, 6), 256, 0, stream>>>(H, DM, WqkvT, 1024, Qb, DM, Kb, Vb);
    attn_naive<<<T * NH / 4, 256, 0, stream>>>(Qb, Kb, Vb, sinks, Qb);
    gemm_rows<false, true><<<T / 16, 256, 0, stream>>>(Qb, DM, 0, WoT, 1024, out, out, post_mix_g + 1024, nullptr, H);
    gemm_tile<1><<<dim3(T / 64, 22), 256, 0, stream>>>(H, DM, WguT + (size_t)5632 * 1024, 1024, ACT, FF, nullptr, nullptr);
    gemm_rows<false, true><<<T / 16, 256, 0, stream>>>(ACT, FF, 0, WdownT + (size_t)1024 * 2816, FF, out, out, post_ffn_g + 1024, nullptr, H);
    gemm_tile<0><<<dim3(T / 64, 4), 256, 0, stream>>>(PB + (size_t)T * PLE, PLE, WprojT + (size_t)1024 * 256, 256, PROJ, DM, nullptr, nullptr);
    gemm_rows<true, false><<<T / 16, 256, 0, stream>>>(H, DM, 0, WgateT + (size_t)1024 * 1024, 1024, out, out, ple_post_g + 1024, PROJ, nullptr);
}
```
